# Optimizing an MI355X kernel written in HIP

```python
import jax, jax.numpy as jnp
from jax import lax
import numpy as np

D_MODEL = 1024
BATCH = 2
SEQ = 8192
DEPTH = 4
DEC_BATCH = 32
DEC_SEQ = 16
PAST_LEN = 1024

CHUNK = 64
N_MIXERS = 2
N_A_LAYERS = (DEPTH + 1) // 2
N_B_LAYERS = DEPTH // 2
CONV_WIDTH = 4
EPS = 1e-6
D_RNN = D_MODEL
LRU_BLOCKS = 4
LRU_BLOCK_W = D_RNN // LRU_BLOCKS
LRU_C = 8.0
SSD_EXPAND = 2
D_INNER = SSD_EXPAND * D_MODEL
SSD_HEAD_DIM = 64
SSD_HEADS = D_INNER // SSD_HEAD_DIM
SSD_GROUPS = 4
SSD_HPG = SSD_HEADS // SSD_GROUPS
SSD_STATE = 128
SSD_GN = SSD_GROUPS * SSD_STATE
SSD_CONV_DIM = D_INNER + 2 * SSD_GN
SSD_IN_DIM = D_INNER + SSD_CONV_DIM + SSD_HEADS
D_FF = -(-8 * D_MODEL // (3 * 256)) * 256

kernel_name = 'hybrid_rglru_ssd_stream_step'


def rmsnorm(x, g):
    xf = x.astype(jnp.float32)
    y = xf * lax.rsqrt(jnp.mean(xf * xf, axis=-1, keepdims=True) + EPS)
    return (y * g.astype(jnp.float32)).astype(x.dtype)


def causal_conv(inp, prev, w, b):
    L = inp.shape[1]
    full = jnp.concatenate([prev.astype(inp.dtype), inp], axis=1)
    out = b + full[:, 0:L] * w[0]
    for k in range(1, CONV_WIDTH):
        out = out + full[:, k:k + L] * w[k]
    return out, full[:, L:]


def _lin_combine(e1, e2):
    a1, b1 = e1
    a2, b2 = e2
    return a1 * a2, a2 * b1 + b2


def rglru_mixer(h, conv_prev, h_prev, w_in, conv_w, conv_b, w_r, b_r, w_i, b_i, lam, w_out):
    bsz, L, _ = h.shape
    proj = h @ w_in
    gate_br, rec_br = proj[..., :D_RNN], proj[..., D_RNN:]
    xc, new_conv = causal_conv(rec_br, conv_prev, conv_w, conv_b)
    xb = xc.reshape(bsz, L, LRU_BLOCKS, LRU_BLOCK_W)
    r = jax.nn.sigmoid(jnp.einsum('blki,kij->blkj', xb, w_r) + b_r).reshape(bsz, L, D_RNN)
    i = jax.nn.sigmoid(jnp.einsum('blki,kij->blkj', xb, w_i) + b_i).reshape(bsz, L, D_RNN)
    log_a = -LRU_C * r.astype(jnp.float32) * jax.nn.softplus(-lam.astype(jnp.float32))
    a = jnp.exp(log_a)
    u = jnp.sqrt(-jnp.expm1(2.0 * log_a)) * (i * xc).astype(jnp.float32)
    a_cum, u_cum = lax.associative_scan(_lin_combine, (a, u), axis=1)
    hs = u_cum + a_cum * h_prev.astype(jnp.float32)[:, None]
    out = (hs.astype(h.dtype) * jax.nn.gelu(gate_br, approximate=True)) @ w_out
    return out, new_conv, hs[:, -1].astype(h.dtype)


def ssd_scan(x, dt, A, Bm, Cm, s0):
    b, L = x.shape[0], x.shape[1]
    q = CHUNK if L % CHUNK == 0 else L
    c = L // q
    G, R, P, N = SSD_GROUPS, SSD_HPG, SSD_HEAD_DIM, SSD_STATE
    dtr = dt.reshape(b, c, q, G, R)
    dA = dtr * A.reshape(G, R)
    xdt = x.reshape(b, c, q, G, R, P) * dtr[..., None]
    Br = Bm.reshape(b, c, q, G, N)
    Cr = Cm.reshape(b, c, q, G, N)
    acs = jnp.cumsum(dA, axis=2)
    seg = acs[:, :, :, None] - acs[:, :, None, :]
    mask = jnp.tril(jnp.ones((q, q), dtype=bool))[:, :, None, None]
    lmat = jnp.exp(jnp.where(mask, seg, -jnp.inf))
    cb = jnp.einsum('bcign,bcjgn->bcijg', Cr, Br)
    y_diag = jnp.einsum('bcijgr,bcjgrp->bcigrp', cb[..., None] * lmat, xdt)
    decay = jnp.exp(acs[:, :, -1:] - acs)
    states = jnp.einsum('bcjgn,bcjgrp->bcgrpn', Br, xdt * decay[..., None])
    blk_decay = jnp.exp(acs[:, :, -1])

    def step(s, inp):
        st, dec = inp
        return s * dec[..., None, None] + st, s

    s_final, s_in = lax.scan(step, s0.reshape(b, G, R, P, N),
                             (jnp.swapaxes(states, 0, 1), jnp.swapaxes(blk_decay, 0, 1)))
    s_in = jnp.swapaxes(s_in, 0, 1)
    y_off = jnp.einsum('bcign,bcgrpn->bcigrp', Cr, s_in) * jnp.exp(acs)[..., None]
    y = (y_diag + y_off).reshape(b, L, SSD_HEADS, P)
    return y, s_final.reshape(b, SSD_HEADS, P, N)


def ssd_mixer(h, conv_prev, s_prev, w_in, conv_w, conv_b, dt_bias, a_log, d_skip, norm_g, w_out):
    bsz, L, _ = h.shape
    proj = h @ w_in
    z = proj[..., :D_INNER]
    xbc = proj[..., D_INNER:D_INNER + SSD_CONV_DIM]
    dt_raw = proj[..., D_INNER + SSD_CONV_DIM:]
    xbc_c, new_conv = causal_conv(xbc, conv_prev, conv_w, conv_b)
    xbc_c = jax.nn.silu(xbc_c).astype(jnp.float32)
    xs = xbc_c[..., :D_INNER].reshape(bsz, L, SSD_HEADS, SSD_HEAD_DIM)
    Bm = xbc_c[..., D_INNER:D_INNER + SSD_GN].reshape(bsz, L, SSD_GROUPS, SSD_STATE)
    Cm = xbc_c[..., D_INNER + SSD_GN:].reshape(bsz, L, SSD_GROUPS, SSD_STATE)
    dt = jax.nn.softplus(dt_raw.astype(jnp.float32) + dt_bias.astype(jnp.float32))
    A = -jnp.exp(a_log.astype(jnp.float32))
    y, s_new = ssd_scan(xs, dt, A, Bm, Cm, s_prev.astype(jnp.float32))
    y = y + d_skip.astype(jnp.float32)[:, None] * xs
    y = y.reshape(bsz, L, D_INNER) * jax.nn.silu(z.astype(jnp.float32))
    yg = y.reshape(bsz, L, SSD_GROUPS, D_INNER // SSD_GROUPS)
    yg = yg * lax.rsqrt(jnp.mean(yg * yg, axis=-1, keepdims=True) + EPS)
    y = (yg.reshape(bsz, L, D_INNER) * norm_g.astype(jnp.float32)).astype(h.dtype)
    return y @ w_out, new_conv, s_new.astype(h.dtype)


def swiglu(h, w_gate, w_up, w_down):
    return (jax.nn.silu(h @ w_gate) * (h @ w_up)) @ w_down


def trunk(x, lru_conv, lru_h, ssd_conv, ssd_s, p):
    new_lc, new_lh, new_sc, new_ss = [], [], [], []
    for layer in range(DEPTH):
        j = layer // N_MIXERS
        hn = rmsnorm(x, p['norm_mix_pre'][layer])
        if layer % N_MIXERS == 0:
            mix, c_new, s_new = rglru_mixer(
                hn, lru_conv[j], lru_h[j], p['lru_w_in'][j], p['lru_conv_w'][j], p['lru_conv_b'][j],
                p['lru_w_r'][j], p['lru_b_r'][j], p['lru_w_i'][j], p['lru_b_i'][j],
                p['lru_lambda'][j], p['lru_w_out'][j])
            new_lc.append(c_new)
            new_lh.append(s_new)
        else:
            mix, c_new, s_new = ssd_mixer(
                hn, ssd_conv[j], ssd_s[j], p['ssd_w_in'][j], p['ssd_conv_w'][j], p['ssd_conv_b'][j],
                p['ssd_dt_bias'][j], p['ssd_a_log'][j], p['ssd_d'][j], p['ssd_norm'][j],
                p['ssd_w_out'][j])
            new_sc.append(c_new)
            new_ss.append(s_new)
        x = x + rmsnorm(mix, p['norm_mix_post'][layer])
        hn = rmsnorm(x, p['norm_ffn_pre'][layer])
        f = swiglu(hn, p['ffn_w_gate'][layer], p['ffn_w_up'][layer], p['ffn_w_down'][layer])
        x = x + rmsnorm(f, p['norm_ffn_post'][layer])
    return x, jnp.stack(new_lc), jnp.stack(new_lh), jnp.stack(new_sc), jnp.stack(new_ss)


def setup_inputs(seed: int = 0) -> dict:
    key = jax.random.key(seed)
    ks = iter(jax.random.split(key, 48))
    f32 = jnp.float32

    def nrm(shape, scale):
        return jax.random.normal(next(ks), shape, f32) * scale

    def gain(shape):
        return 1.0 + 0.05 * jax.random.normal(next(ks), shape, f32)

    NA, NB = N_A_LAYERS, N_B_LAYERS
    a0 = jax.random.uniform(next(ks), (NA, D_RNN), f32, 0.9, 0.999)
    dt0 = jnp.exp(jax.random.uniform(next(ks), (NB, SSD_HEADS), f32, np.log(1e-3), np.log(1e-1)))
    return {
        'x_prompt': nrm((BATCH, SEQ, D_MODEL), 1.0),
        'x_sample': nrm((DEC_BATCH, DEC_SEQ, D_MODEL), 1.0),
        'state_lru_conv': nrm((NA, DEC_BATCH, CONV_WIDTH - 1, D_RNN), 1.0),
        'state_lru_h': nrm((NA, DEC_BATCH, D_RNN), 0.5),
        'state_ssd_conv': nrm((NB, DEC_BATCH, CONV_WIDTH - 1, SSD_CONV_DIM), 1.0),
        'state_ssd': nrm((NB, DEC_BATCH, SSD_HEADS, SSD_HEAD_DIM, SSD_STATE), 0.1),
        'norm_mix_pre': gain((DEPTH, D_MODEL)),
        'norm_mix_post': gain((DEPTH, D_MODEL)),
        'norm_ffn_pre': gain((DEPTH, D_MODEL)),
        'norm_ffn_post': gain((DEPTH, D_MODEL)),
        'lru_w_in': nrm((NA, D_MODEL, 2 * D_RNN), D_MODEL ** -0.5),
        'lru_conv_w': nrm((NA, CONV_WIDTH, D_RNN), CONV_WIDTH ** -0.5),
        'lru_conv_b': nrm((NA, D_RNN), 0.01),
        'lru_w_r': nrm((NA, LRU_BLOCKS, LRU_BLOCK_W, LRU_BLOCK_W), LRU_BLOCK_W ** -0.5),
        'lru_b_r': nrm((NA, LRU_BLOCKS, LRU_BLOCK_W), 0.01),
        'lru_w_i': nrm((NA, LRU_BLOCKS, LRU_BLOCK_W, LRU_BLOCK_W), LRU_BLOCK_W ** -0.5),
        'lru_b_i': nrm((NA, LRU_BLOCKS, LRU_BLOCK_W), 0.01),
        'lru_lambda': jnp.log(a0) - jnp.log1p(-a0),
        'lru_w_out': nrm((NA, D_RNN, D_MODEL), D_RNN ** -0.5),
        'ssd_w_in': nrm((NB, D_MODEL, SSD_IN_DIM), D_MODEL ** -0.5),
        'ssd_conv_w': nrm((NB, CONV_WIDTH, SSD_CONV_DIM), CONV_WIDTH ** -0.5),
        'ssd_conv_b': nrm((NB, SSD_CONV_DIM), 0.01),
        'ssd_dt_bias': dt0 + jnp.log(-jnp.expm1(-dt0)),
        'ssd_a_log': jnp.log(jax.random.uniform(next(ks), (NB, SSD_HEADS), f32, 1.0, 16.0)),
        'ssd_d': 1.0 + 0.1 * jax.random.normal(next(ks), (NB, SSD_HEADS), f32),
        'ssd_norm': gain((NB, D_INNER)),
        'ssd_w_out': nrm((NB, D_INNER, D_MODEL), D_INNER ** -0.5),
        'ffn_w_gate': nrm((DEPTH, D_MODEL, D_FF), D_MODEL ** -0.5),
        'ffn_w_up': nrm((DEPTH, D_MODEL, D_FF), D_MODEL ** -0.5),
        'ffn_w_down': nrm((DEPTH, D_FF, D_MODEL), D_FF ** -0.5),
    }


def reference(x_prompt, x_sample, state_lru_conv, state_lru_h, state_ssd_conv, state_ssd,
              norm_mix_pre, norm_mix_post, norm_ffn_pre, norm_ffn_post,
              lru_w_in, lru_conv_w, lru_conv_b, lru_w_r, lru_b_r, lru_w_i, lru_b_i, lru_lambda, lru_w_out,
              ssd_w_in, ssd_conv_w, ssd_conv_b, ssd_dt_bias, ssd_a_log, ssd_d, ssd_norm, ssd_w_out,
              ffn_w_gate, ffn_w_up, ffn_w_down):
    p = dict(norm_mix_pre=norm_mix_pre, norm_mix_post=norm_mix_post,
             norm_ffn_pre=norm_ffn_pre, norm_ffn_post=norm_ffn_post,
             lru_w_in=lru_w_in, lru_conv_w=lru_conv_w, lru_conv_b=lru_conv_b,
             lru_w_r=lru_w_r, lru_b_r=lru_b_r, lru_w_i=lru_w_i, lru_b_i=lru_b_i,
             lru_lambda=lru_lambda, lru_w_out=lru_w_out,
             ssd_w_in=ssd_w_in, ssd_conv_w=ssd_conv_w, ssd_conv_b=ssd_conv_b,
             ssd_dt_bias=ssd_dt_bias, ssd_a_log=ssd_a_log, ssd_d=ssd_d, ssd_norm=ssd_norm,
             ssd_w_out=ssd_w_out, ffn_w_gate=ffn_w_gate, ffn_w_up=ffn_w_up, ffn_w_down=ffn_w_down)
    bp = x_prompt.shape[0]
    dt_ = x_prompt.dtype
    z_lc = jnp.zeros((N_A_LAYERS, bp, CONV_WIDTH - 1, D_RNN), dt_)
    z_lh = jnp.zeros((N_A_LAYERS, bp, D_RNN), dt_)
    z_sc = jnp.zeros((N_B_LAYERS, bp, CONV_WIDTH - 1, SSD_CONV_DIM), dt_)
    z_ss = jnp.zeros((N_B_LAYERS, bp, SSD_HEADS, SSD_HEAD_DIM, SSD_STATE), dt_)
    y_prompt, p_lc, p_lh, p_sc, p_ss = trunk(x_prompt, z_lc, z_lh, z_sc, z_ss, p)
    y_sample, s_lc, s_lh, s_sc, s_ss = trunk(x_sample, state_lru_conv, state_lru_h,
                                             state_ssd_conv, state_ssd, p)
    return (y_prompt, y_sample, p_lc, p_lh, p_sc, p_ss, s_lc, s_lh, s_sc, s_ss)
```

```cpp
#include <hip/hip_runtime.h>
#include <cstdint>
#include <cmath>
namespace refn {
constexpr int DM = 1024, SEQ = 8192, NBATCH = 2, DEC_B = 32, DEC_L = 16, DEPTH = 4;
constexpr int D_INNER = 2048, SSD_H = 32, SSD_P = 64, SSD_N = 128, SSD_CONV = 3072, SSD_IN = 5152, D_FF = 2816;
constexpr float EPS = 1e-6f;

__device__ __forceinline__ float sigmoidf_(float x) { return 1.f / (1.f + expf(-x)); }
__device__ __forceinline__ float siluf_(float x) { return x * sigmoidf_(x); }
__device__ __forceinline__ float softplusf_(float x) { return fmaxf(x, 0.f) + log1pf(expf(-fabsf(x))); }
__device__ __forceinline__ float gelu_tanh_(float x) { return 0.5f * x * (1.f + tanhf(0.7978845608028654f * (x + 0.044715f * x * x * x))); }
__device__ __forceinline__ float bf16r(float f) { unsigned u = __float_as_uint(f); u = (u + 0x7fffu + ((u >> 16) & 1u)) & 0xffff0000u; return __uint_as_float(u); }

__device__ __forceinline__ float block_sum256(float v, float* red) {
    for (int o = 32; o > 0; o >>= 1) v += __shfl_xor(v, o);
    const int w = threadIdx.x >> 6;
    __syncthreads();
    if ((threadIdx.x & 63) == 0) red[w] = v;
    __syncthreads();
    return red[0] + red[1] + red[2] + red[3];
}

__global__ void k_rmsnorm(const float* __restrict__ x, const float* __restrict__ g, float* __restrict__ out) {
    __shared__ float red[4];
    const size_t row = blockIdx.x; const int t = threadIdx.x;
    const float4 v = ((const float4*)(x + row * DM))[t];
    const float ss = block_sum256(v.x * v.x + v.y * v.y + v.z * v.z + v.w * v.w, red);
    const float r = rsqrtf(ss * (1.f / DM) + EPS);
    const float4 gg = ((const float4*)g)[t];
    float4 o; o.x = v.x * r * gg.x; o.y = v.y * r * gg.y; o.z = v.z * r * gg.z; o.w = v.w * r * gg.w;
    ((float4*)(out + row * DM))[t] = o;
}
__global__ void k_rmsnorm_add(const float* __restrict__ m, const float* __restrict__ g, float* __restrict__ x) {
    __shared__ float red[4];
    const size_t row = blockIdx.x; const int t = threadIdx.x;
    const float4 v = ((const float4*)(m + row * DM))[t];
    const float ss = block_sum256(v.x * v.x + v.y * v.y + v.z * v.z + v.w * v.w, red);
    const float r = rsqrtf(ss * (1.f / DM) + EPS);
    const float4 gg = ((const float4*)g)[t];
    float4 xo = ((float4*)(x + row * DM))[t];
    xo.x += v.x * r * gg.x; xo.y += v.y * r * gg.y; xo.z += v.z * r * gg.z; xo.w += v.w * r * gg.w;
    ((float4*)(x + row * DM))[t] = xo;
}

template <bool RB>
__global__ void __launch_bounds__(256) k_sgemm(const float* __restrict__ A, const float* __restrict__ B, float* __restrict__ C, int M, int N, int K, int lda, int ldb, int ldc) {
    __shared__ float As[8][128 + 4];
    __shared__ float Bs[8][128 + 4];
    const int tid = threadIdx.x, tx = tid & 15, ty = tid >> 4;
    const int m0 = blockIdx.y * 128, n0 = blockIdx.x * 128;
    float acc[8][8];
#pragma unroll
    for (int i = 0; i < 8; ++i)
#pragma unroll
        for (int j = 0; j < 8; ++j) acc[i][j] = 0.f;
    const int ar = tid >> 1, ak = (tid & 1) * 4;
    const int bk = tid >> 5, bn = (tid & 31) * 4;
    const bool bok = (n0 + bn) < N;
    for (int k0 = 0; k0 < K; k0 += 8) {
        float4 av = *(const float4*)(A + (size_t)(m0 + ar) * lda + k0 + ak);
        float4 bv = bok ? *(const float4*)(B + (size_t)(k0 + bk) * ldb + n0 + bn) : make_float4(0.f, 0.f, 0.f, 0.f);
        if (RB) { av.x = bf16r(av.x); av.y = bf16r(av.y); av.z = bf16r(av.z); av.w = bf16r(av.w); bv.x = bf16r(bv.x); bv.y = bf16r(bv.y); bv.z = bf16r(bv.z); bv.w = bf16r(bv.w); }
        __syncthreads();
        As[ak + 0][ar] = av.x; As[ak + 1][ar] = av.y; As[ak + 2][ar] = av.z; As[ak + 3][ar] = av.w;
        *(float4*)&Bs[bk][bn] = bv;
        __syncthreads();
#pragma unroll
        for (int kk = 0; kk < 8; ++kk) {
            float a[8], b[8];
            *(float4*)&a[0] = *(const float4*)&As[kk][ty * 4]; *(float4*)&a[4] = *(const float4*)&As[kk][64 + ty * 4];
            *(float4*)&b[0] = *(const float4*)&Bs[kk][tx * 4]; *(float4*)&b[4] = *(const float4*)&Bs[kk][64 + tx * 4];
#pragma unroll
            for (int i = 0; i < 8; ++i)
#pragma unroll
                for (int j = 0; j < 8; ++j) acc[i][j] = fmaf(a[i], b[j], acc[i][j]);
        }
    }
#pragma unroll
    for (int i = 0; i < 8; ++i) {
        const int r = m0 + (i < 4 ? ty * 4 + i : 64 + ty * 4 + (i - 4));
#pragma unroll
        for (int jh = 0; jh < 2; ++jh) {
            const int c = n0 + jh * 64 + tx * 4;
            if (c < N) *(float4*)(C + (size_t)r * ldc + c) = make_float4(acc[i][jh * 4 + 0], acc[i][jh * 4 + 1], acc[i][jh * 4 + 2], acc[i][jh * 4 + 3]);
        }
    }
}

__global__ void k_conv(const float* __restrict__ inp, int ldi, const float* __restrict__ prev, const float* __restrict__ w, const float* __restrict__ b,
                       float* __restrict__ out, int ldo, float* __restrict__ ostate, int C, int L, int act) {
    const int c = blockIdx.x * 256 + threadIdx.x; const int r = blockIdx.y; const int s = r / L, t = r % L;
    float acc = b[c];
#pragma unroll
    for (int k = 0; k < 4; ++k) {
        const int tt = t + k - 3; float v;
        if (tt >= 0) v = inp[(size_t)(s * L + tt) * ldi + c];
        else v = prev ? prev[((size_t)s * 3 + (tt + 3)) * C + c] : 0.f;
        acc += v * w[k * C + c];
    }
    if (act == 1) acc = siluf_(acc);
    out[(size_t)r * ldo + c] = acc;
    if (t >= L - 3) ostate[((size_t)s * 3 + (t - (L - 3))) * C + c] = inp[(size_t)r * ldi + c];
}

__global__ void k_lru_gates(float* __restrict__ rpre, float* __restrict__ ipre, const float* __restrict__ xc, const float* __restrict__ br, const float* __restrict__ bi, const float* __restrict__ lam, size_t n) {
    const size_t i = (size_t)blockIdx.x * 256 + threadIdx.x; if (i >= n) return;
    const int c = (int)(i & 1023);
    const float r = sigmoidf_(rpre[i] + br[c]), ig = sigmoidf_(ipre[i] + bi[c]);
    const float log_a = -8.0f * r * softplusf_(-lam[c]);
    const float a = expf(log_a);
    const float u = sqrtf(-expm1f(2.0f * log_a)) * (ig * xc[i]);
    rpre[i] = a; ipre[i] = u;
}
__global__ void k_lru_scan(const float* __restrict__ a, float* __restrict__ u, const float* __restrict__ hprev, float* __restrict__ hout, int L) {
    const int i = blockIdx.x * 256 + threadIdx.x; const int s = i >> 10, c = i & 1023;
    float h = hprev ? hprev[(size_t)s * 1024 + c] : 0.f;
    const size_t base = (size_t)s * L * 1024 + c;
    for (int t = 0; t < L; t += 8) {
        float av[8], uv[8];
#pragma unroll
        for (int j = 0; j < 8; ++j) { av[j] = a[base + (size_t)(t + j) * 1024]; uv[j] = u[base + (size_t)(t + j) * 1024]; }
#pragma unroll
        for (int j = 0; j < 8; ++j) { h = av[j] * h + uv[j]; u[base + (size_t)(t + j) * 1024] = h; }
    }
    hout[(size_t)s * 1024 + c] = h;
}
__global__ void k_lru_out(const float* __restrict__ hs, const float* __restrict__ proj, float* __restrict__ out, size_t n) {
    const size_t i = (size_t)blockIdx.x * 256 + threadIdx.x; if (i >= n) return;
    const size_t r = i >> 10; const int c = (int)(i & 1023);
    out[i] = hs[i] * gelu_tanh_(proj[r * 2048 + c]);
}
__global__ void k_ssd_dt(const float* __restrict__ proj, const float* __restrict__ bias, float* __restrict__ dtv, int R) {
    const int i = blockIdx.x * 256 + threadIdx.x; if (i >= R * 32) return;
    const int r = i >> 5, h = i & 31;
    dtv[i] = softplusf_(proj[(size_t)r * SSD_IN + 5120 + h] + bias[h]);
}
__global__ void __launch_bounds__(64) k_ssd_rec(float* __restrict__ xbc, const float* __restrict__ dtv, const float* __restrict__ a_log, const float* __restrict__ dskip,
                                                const float* __restrict__ sprev, float* __restrict__ sout, int L) {
    __shared__ float Bs[8][128], Cs[8][128];
    const int s = blockIdx.x / SSD_H, h = blockIdx.x % SSD_H, p = threadIdx.x, g = h / 8;
    float st[128];
    const size_t sbase = (((size_t)s * SSD_H + h) * SSD_P + p) * SSD_N;
#pragma unroll
    for (int n = 0; n < 128; ++n) st[n] = sprev ? sprev[sbase + n] : 0.f;
    const float A = -expf(a_log[h]), Dk = dskip[h];
    for (int t0 = 0; t0 < L; t0 += 8) {
        __syncthreads();
        for (int e = p; e < 8 * 128; e += 64) { const int j = e >> 7, n = e & 127; const size_t row = (size_t)s * L + t0 + j;
            Bs[j][n] = xbc[row * SSD_CONV + 2048 + g * 128 + n]; Cs[j][n] = xbc[row * SSD_CONV + 2560 + g * 128 + n]; }
        __syncthreads();
#pragma unroll 1
        for (int j = 0; j < 8; ++j) {
            const size_t row = (size_t)s * L + t0 + j;
            const float x = xbc[row * SSD_CONV + h * 64 + p], dt = dtv[row * 32 + h];
            const float dA = expf(dt * A), xdt = x * dt;
            float y = 0.f;
#pragma unroll
            for (int n = 0; n < 128; ++n) { st[n] = st[n] * dA + xdt * Bs[j][n]; y = fmaf(Cs[j][n], st[n], y); }
            xbc[row * SSD_CONV + h * 64 + p] = y + Dk * x;
        }
    }
#pragma unroll
    for (int n = 0; n < 128; ++n) sout[sbase + n] = st[n];
}
__global__ void k_ssd_gate_norm(float* __restrict__ xbc, const float* __restrict__ proj, const float* __restrict__ ng) {
    __shared__ float red[4];
    const size_t r = blockIdx.x >> 2; const int g = blockIdx.x & 3, t = threadIdx.x;
    float* yp = xbc + r * SSD_CONV + g * 512; const float* zp = proj + r * SSD_IN + g * 512;
    const float y0 = yp[t] * siluf_(zp[t]), y1 = yp[t + 256] * siluf_(zp[t + 256]);
    const float ss = block_sum256(y0 * y0 + y1 * y1, red);
    const float rr = rsqrtf(ss * (1.f / 512.f) + EPS);
    yp[t] = y0 * rr * ng[g * 512 + t]; yp[t + 256] = y1 * rr * ng[g * 512 + t + 256];
}
__global__ void k_swiglu(float* __restrict__ gate, const float* __restrict__ up, size_t n) {
    const size_t i = (size_t)blockIdx.x * 256 + threadIdx.x; if (i >= n) return;
    gate[i] = siluf_(gate[i]) * up[i];
}

template <bool RB>
static void sgemm(hipStream_t st, const float* A, const float* B, float* C, int M, int N, int K, int lda, int ldb, int ldc) {
    dim3 grid((N + 127) / 128, M / 128);
    hipLaunchKernelGGL((k_sgemm<RB>), grid, dim3(256), 0, st, A, B, C, M, N, K, lda, ldb, ldc);
}

struct Seg { float* x; int R, nseq, L; const float* lc_prev; const float* lh_prev; const float* sc_prev; const float* ss_prev; float* o_lc; float* o_lh; float* o_sc; float* o_ss;
             size_t lc_stride, lh_stride, sc_stride, ss_stride; };

template <bool RB>
static void run_segment(hipStream_t st, void* const* d_in, const Seg& sg, float* bufA, float* bufB, float* bufC, float* bufD) {
    const float* const* in = (const float* const*)d_in;
    const int R = sg.R, L = sg.L, nseq = sg.nseq;
    for (int layer = 0; layer < DEPTH; ++layer) {
        const int j = layer / 2;
        hipLaunchKernelGGL(k_rmsnorm, dim3(R), dim3(256), 0, st, sg.x, in[6] + layer * DM, bufA);
        if (layer % 2 == 0) {
            sgemm<RB>(st, bufA, in[10] + (size_t)j * DM * 2048, bufB, R, 2048, DM, DM, 2048, 2048);
            float* xc = bufC; float* rp = bufC + (size_t)R * 1024; float* ip = bufC + (size_t)2 * R * 1024;
            hipLaunchKernelGGL(k_conv, dim3(1024 / 256, R), dim3(256), 0, st, bufB + 1024, 2048, sg.lc_prev ? sg.lc_prev + j * sg.lc_stride : nullptr,
                               in[11] + (size_t)j * 4 * 1024, in[12] + (size_t)j * 1024, xc, 1024, sg.o_lc + j * sg.lc_stride, 1024, L, 0);
            for (int k = 0; k < 4; ++k) {
                sgemm<RB>(st, xc + 256 * k, in[13] + ((size_t)j * 4 + k) * 65536, rp + 256 * k, R, 256, 256, 1024, 256, 1024);
                sgemm<RB>(st, xc + 256 * k, in[15] + ((size_t)j * 4 + k) * 65536, ip + 256 * k, R, 256, 256, 1024, 256, 1024);
            }
            const size_t n = (size_t)R * 1024;
            hipLaunchKernelGGL(k_lru_gates, dim3((unsigned)((n + 255) / 256)), dim3(256), 0, st, rp, ip, xc, in[14] + (size_t)j * 1024, in[16] + (size_t)j * 1024, in[17] + (size_t)j * 1024, n);
            hipLaunchKernelGGL(k_lru_scan, dim3(nseq * 1024 / 256), dim3(256), 0, st, rp, ip, sg.lh_prev ? sg.lh_prev + j * sg.lh_stride : nullptr, sg.o_lh + j * sg.lh_stride, L);
            hipLaunchKernelGGL(k_lru_out, dim3((unsigned)((n + 255) / 256)), dim3(256), 0, st, ip, bufB, rp, n);
            sgemm<RB>(st, rp, in[18] + (size_t)j * 1024 * 1024, bufA, R, 1024, 1024, 1024, 1024, 1024);
        } else {
            sgemm<RB>(st, bufA, in[19] + (size_t)j * DM * SSD_IN, bufB, R, SSD_IN, DM, DM, SSD_IN, SSD_IN);
            hipLaunchKernelGGL(k_conv, dim3(SSD_CONV / 256, R), dim3(256), 0, st, bufB + 2048, SSD_IN, sg.sc_prev ? sg.sc_prev + j * sg.sc_stride : nullptr,
                               in[20] + (size_t)j * 4 * SSD_CONV, in[21] + (size_t)j * SSD_CONV, bufC, SSD_CONV, sg.o_sc + j * sg.sc_stride, SSD_CONV, L, 1);
            hipLaunchKernelGGL(k_ssd_dt, dim3((R * 32 + 255) / 256), dim3(256), 0, st, bufB, in[22] + j * 32, bufD, R);
            hipLaunchKernelGGL(k_ssd_rec, dim3(nseq * SSD_H), dim3(64), 0, st, bufC, bufD, in[23] + j * 32, in[24] + j * 32,
                               sg.ss_prev ? sg.ss_prev + j * sg.ss_stride : nullptr, sg.o_ss + j * sg.ss_stride, L);
            hipLaunchKernelGGL(k_ssd_gate_norm, dim3(R * 4), dim3(256), 0, st, bufC, bufB, in[25] + (size_t)j * D_INNER);
            sgemm<RB>(st, bufC, in[26] + (size_t)j * D_INNER * DM, bufA, R, DM, D_INNER, SSD_CONV, DM, DM);
        }
        hipLaunchKernelGGL(k_rmsnorm_add, dim3(R), dim3(256), 0, st, bufA, in[7] + layer * DM, sg.x);
        hipLaunchKernelGGL(k_rmsnorm, dim3(R), dim3(256), 0, st, sg.x, in[8] + layer * DM, bufA);
        float* gate = bufB; float* up = bufB + (size_t)R * D_FF;
        sgemm<RB>(st, bufA, in[27] + (size_t)layer * DM * D_FF, gate, R, D_FF, DM, DM, D_FF, D_FF);
        sgemm<RB>(st, bufA, in[28] + (size_t)layer * DM * D_FF, up, R, D_FF, DM, DM, D_FF, D_FF);
        const size_t nf = (size_t)R * D_FF;
        hipLaunchKernelGGL(k_swiglu, dim3((unsigned)((nf + 255) / 256)), dim3(256), 0, st, gate, up, nf);
        sgemm<RB>(st, gate, in[29] + (size_t)layer * D_FF * DM, bufA, R, DM, D_FF, D_FF, DM, DM);
        hipLaunchKernelGGL(k_rmsnorm_add, dim3(R), dim3(256), 0, st, bufA, in[9] + layer * DM, sg.x);
    }
}

constexpr size_t O_YP = 0, O_YS = O_YP + (size_t)NBATCH * SEQ * DM, O_PLC = O_YS + (size_t)DEC_B * DEC_L * DM, O_PLH = O_PLC + 2 * NBATCH * 3 * 1024,
                 O_PSC = O_PLH + 2 * NBATCH * 1024, O_PSS = O_PSC + 2 * NBATCH * 3 * SSD_CONV, O_SLC = O_PSS + (size_t)2 * NBATCH * SSD_H * SSD_P * SSD_N,
                 O_SLH = O_SLC + 2 * DEC_B * 3 * 1024, O_SSC = O_SLH + 2 * DEC_B * 1024, O_SSS = O_SSC + 2 * DEC_B * 3 * SSD_CONV,
                 O_END = O_SSS + (size_t)2 * DEC_B * SSD_H * SSD_P * SSD_N;

template <bool RB>
static void forward(hipStream_t st, void* const* d_in, float* out, unsigned char* ws_base) {
    float* bufA = (float*)ws_base; float* bufB = bufA + (size_t)8192 * 1024; float* bufC = bufB + (size_t)8192 * 5632; float* bufD = bufC + (size_t)8192 * 3072;
    hipMemcpyAsync(out + O_YP, d_in[0], (size_t)NBATCH * SEQ * DM * 4, hipMemcpyDeviceToDevice, st);
    hipMemcpyAsync(out + O_YS, d_in[1], (size_t)DEC_B * DEC_L * DM * 4, hipMemcpyDeviceToDevice, st);
    const float* const* in = (const float* const*)d_in;
    for (int b = 0; b < NBATCH; ++b) {
        Seg sg{}; sg.x = out + O_YP + (size_t)b * SEQ * DM; sg.R = SEQ; sg.nseq = 1; sg.L = SEQ;
        sg.o_lc = out + O_PLC + (size_t)b * 3 * 1024; sg.lc_stride = (size_t)NBATCH * 3 * 1024;
        sg.o_lh = out + O_PLH + (size_t)b * 1024; sg.lh_stride = (size_t)NBATCH * 1024;
        sg.o_sc = out + O_PSC + (size_t)b * 3 * SSD_CONV; sg.sc_stride = (size_t)NBATCH * 3 * SSD_CONV;
        sg.o_ss = out + O_PSS + (size_t)b * SSD_H * SSD_P * SSD_N; sg.ss_stride = (size_t)NBATCH * SSD_H * SSD_P * SSD_N;
        run_segment<RB>(st, d_in, sg, bufA, bufB, bufC, bufD);
    }
    {
        Seg sg{}; sg.x = out + O_YS; sg.R = DEC_B * DEC_L; sg.nseq = DEC_B; sg.L = DEC_L;
        sg.lc_prev = in[2]; sg.lh_prev = in[3]; sg.sc_prev = in[4]; sg.ss_prev = in[5];
        sg.o_lc = out + O_SLC; sg.lc_stride = (size_t)DEC_B * 3 * 1024;
        sg.o_lh = out + O_SLH; sg.lh_stride = (size_t)DEC_B * 1024;
        sg.o_sc = out + O_SSC; sg.sc_stride = (size_t)DEC_B * 3 * SSD_CONV;
        sg.o_ss = out + O_SSS; sg.ss_stride = (size_t)DEC_B * SSD_H * SSD_P * SSD_N;
        run_segment<RB>(st, d_in, sg, bufA, bufB, bufC, bufD);
    }
}
}
extern "C" void kernel_launch(void* const* d_in, const int* in_sizes, int n_in, void* d_out, int out_size, void* d_ws, size_t ws_size, hipStream_t stream) {
    const size_t need = (size_t)8192 * (1024 + 5632 + 3072 + 32) * 4;
    if (n_in != 30 || (size_t)out_size != refn::O_END || ws_size < need) return;
    refn::forward<false>(stream, d_in, (float*)d_out, (unsigned char*)d_ws);
}
```
